# Optimizing an MI355X kernel written in HIP

```python
import jax
import jax.numpy as jnp
from jax import lax
import numpy as np


D_MODEL = 1024
BATCH = 2
SEQ = 8192
DEPTH = 1

CHUNK = 64
D_MIX = D_MODEL
RET_WIDTH = D_MIX // 2
RET_HEADS = 4
RET_DK = RET_WIDTH // RET_HEADS
RET_DV = RET_WIDTH // RET_HEADS
ROPE_BASE = 10000.0
GLA_WIDTH = D_MIX - RET_WIDTH
GLA_HEADS = 4
GLA_KEY_WIDTH = GLA_WIDTH // 2
GLA_DK = GLA_KEY_WIDTH // GLA_HEADS
GLA_DV = GLA_WIDTH // GLA_HEADS
GLA_GATE_RANK = 16
GLA_GATE_TAU = 16.0
D_FF = 4 * D_MODEL
LN_EPS = 1e-5
DEEPNORM_ALPHA = (2.0 * DEPTH) ** 0.25
DEEPNORM_BETA = (8.0 * DEPTH) ** -0.25
IN_SPLITS = (RET_WIDTH, RET_WIDTH, RET_WIDTH, RET_WIDTH,
             GLA_KEY_WIDTH, GLA_KEY_WIDTH, GLA_WIDTH, GLA_WIDTH, GLA_GATE_RANK)
D_IN_PROJ = sum(IN_SPLITS)
VALUE_SLOTS = (2, 6)

kernel_name = 'hybrid_retention_gla_deepnorm_adaln'


def _layer_norm(x, w=None, b=None):
    xf = x.astype(jnp.float32)
    mu = jnp.mean(xf, axis=-1, keepdims=True)
    var = jnp.mean(jnp.square(xf - mu), axis=-1, keepdims=True)
    y = (xf - mu) * lax.rsqrt(var + LN_EPS)
    if w is not None:
        y = y * w.astype(jnp.float32) + b.astype(jnp.float32)
    return y.astype(x.dtype)


def _head_norm(o, w, center):
    if center:
        o = o - jnp.mean(o, axis=-1, keepdims=True)
    o = o * lax.rsqrt(jnp.mean(jnp.square(o), axis=-1, keepdims=True) + LN_EPS)
    B, S, H, d = o.shape
    return o.reshape(B, S, H * d) * w.astype(jnp.float32)


def _rotary(x, pos):
    half = x.shape[-1] // 2
    inv = 1.0 / (ROPE_BASE ** jnp.linspace(0.0, 1.0, half, dtype=jnp.float32))
    ang = pos[:, None] * inv[None, :]
    cos = jnp.cos(ang)[:, None, :]
    sin = jnp.sin(ang)[:, None, :]
    x1, x2 = x[..., :half], x[..., half:]
    return jnp.concatenate([x1 * cos - x2 * sin, x2 * cos + x1 * sin], axis=-1)


def _retention(q, k, v):
    B, S, H, dk = q.shape
    dv = v.shape[-1]
    N = S // CHUNK
    log_gamma = jnp.log(1.0 - 2.0 ** (-5.0 - jnp.arange(H, dtype=jnp.float32)))
    pos = jnp.arange(S, dtype=jnp.float32)
    q = _rotary(q, pos) * (dk ** -0.5)
    k = _rotary(k, pos)
    qc = q.reshape(B, N, CHUNK, H, dk)
    kc = k.reshape(B, N, CHUNK, H, dk)
    vc = v.reshape(B, N, CHUNK, H, dv)
    idx = jnp.arange(CHUNK, dtype=jnp.float32)
    dist = jnp.abs(idx[:, None] - idx[None, :])
    intra_decay = jnp.exp(log_gamma[:, None, None] * dist)
    scores = jnp.einsum('bnchd,bnshd->bnhcs', qc, kc) * intra_decay
    o = jnp.einsum('bnhcs,bnshe->bnche', scores, vc)
    k_decay = jnp.exp(log_gamma[None, :] * (CHUNK - 1.0 - idx)[:, None])
    q_decay = jnp.exp(log_gamma[None, :] * (idx + 1.0)[:, None])
    chunk_decay = jnp.exp(log_gamma * CHUNK)[None, :, None, None]
    U = jnp.einsum('bnshd,bnshe->nbhde', kc * k_decay[:, :, None], vc)

    def step(R, U_i):
        return chunk_decay * R + U_i, R

    _, R_prev = lax.scan(step, jnp.zeros((B, H, dk, dv), jnp.float32), U)
    o = o + jnp.einsum('bnchd,nbhde->bnche', qc * q_decay[:, :, None], R_prev)
    return o.reshape(B, S, H, dv)


def _gla(q, k, v, log_a):
    B, S, H, dk = q.shape
    dv = v.shape[-1]
    N = S // CHUNK
    q = q * (dk ** -0.5)

    def to_chunks(t):
        return t.reshape(B, N, CHUNK, H, t.shape[-1]).transpose(1, 0, 2, 3, 4)

    def step(state, inp):
        qi, ki, vi, lai = inp
        b = jnp.cumsum(lai, axis=1)
        decay = jnp.exp(-jnp.abs(b[:, :, None] - b[:, None, :]))
        A = jnp.einsum('bthd,bshd,btshd->bhts', qi, ki, decay)
        o = jnp.einsum('bhts,bshe->bthe', A, vi)
        o = o + jnp.einsum('bthd,bhde->bthe', qi * jnp.exp(b), state)
        b_last = b[:, -1]
        new_state = jnp.exp(b_last)[..., None] * state + jnp.einsum(
            'bshd,bshe->bhde', ki * jnp.exp(b_last[:, None] - b), vi)
        return new_state, o

    _, o = lax.scan(step, jnp.zeros((B, H, dk, dv), jnp.float32),
                    (to_chunks(q), to_chunks(k), to_chunks(v), to_chunks(log_a)))
    return o.transpose(1, 0, 2, 3, 4).reshape(B, S, H, dv)


def _token_mixer(u, w_in, ret_norm_w, gla_gate_w, gla_gate_b, gla_norm_w, w_out):
    B, S, _ = u.shape
    proj = (u @ w_in).astype(jnp.float32)
    cuts = [int(v) for v in np.cumsum(IN_SPLITS)[:-1]]
    rq, rk, rv, rg, gq, gk, gv, gg, glr = jnp.split(proj, cuts, axis=-1)
    ro = _retention(rq.reshape(B, S, RET_HEADS, RET_DK),
                    rk.reshape(B, S, RET_HEADS, RET_DK),
                    rv.reshape(B, S, RET_HEADS, RET_DV))
    ro = _head_norm(ro, ret_norm_w, center=True) * jax.nn.silu(rg)
    gate_logit = glr @ gla_gate_w.astype(jnp.float32) + gla_gate_b.astype(jnp.float32)
    log_a = jax.nn.log_sigmoid(gate_logit) / GLA_GATE_TAU
    go = _gla(gq.reshape(B, S, GLA_HEADS, GLA_DK),
              gk.reshape(B, S, GLA_HEADS, GLA_DK),
              gv.reshape(B, S, GLA_HEADS, GLA_DV),
              log_a.reshape(B, S, GLA_HEADS, GLA_DK))
    go = _head_norm(go, gla_norm_w, center=False) * jax.nn.silu(gg)
    mixed = jnp.concatenate([ro, go], axis=-1).astype(u.dtype)
    return mixed @ w_out


def setup_inputs(seed: int = 0) -> dict:
    key = jax.random.key(seed)
    ks = jax.random.split(key, 16)
    nrm = jax.random.normal
    offs = np.concatenate([[0], np.cumsum(IN_SPLITS)])
    col_scale = np.ones((D_IN_PROJ,), np.float32)
    for slot in VALUE_SLOTS:
        col_scale[int(offs[slot]):int(offs[slot + 1])] = DEEPNORM_BETA
    return {
        'x': nrm(ks[0], (BATCH, SEQ, D_MODEL), jnp.float32),
        'c': nrm(ks[1], (BATCH, D_MODEL), jnp.float32),
        'w_ada': nrm(ks[2], (DEPTH, D_MODEL, 6 * D_MODEL), jnp.float32) * (0.5 * D_MODEL ** -0.5),
        'b_ada': 0.02 * nrm(ks[3], (DEPTH, 6 * D_MODEL), jnp.float32),
        'w_in': nrm(ks[4], (DEPTH, D_MODEL, D_IN_PROJ), jnp.float32) * (D_MODEL ** -0.5) * jnp.asarray(col_scale),
        'ret_norm_w': 1.0 + 0.02 * nrm(ks[5], (DEPTH, RET_WIDTH), jnp.float32),
        'gla_gate_w': nrm(ks[6], (DEPTH, GLA_GATE_RANK, GLA_KEY_WIDTH), jnp.float32) * (GLA_GATE_RANK ** -0.5),
        'gla_gate_b': 0.1 * nrm(ks[7], (DEPTH, GLA_KEY_WIDTH), jnp.float32),
        'gla_norm_w': 1.0 + 0.02 * nrm(ks[8], (DEPTH, GLA_WIDTH), jnp.float32),
        'w_out': nrm(ks[9], (DEPTH, D_MIX, D_MODEL), jnp.float32) * (D_MIX ** -0.5) * DEEPNORM_BETA,
        'ln1_w': 1.0 + 0.02 * nrm(ks[10], (DEPTH, D_MODEL), jnp.float32),
        'ln1_b': 0.02 * nrm(ks[11], (DEPTH, D_MODEL), jnp.float32),
        'w_ff1': nrm(ks[12], (DEPTH, D_MODEL, D_FF), jnp.float32) * (D_MODEL ** -0.5) * DEEPNORM_BETA,
        'w_ff2': nrm(ks[13], (DEPTH, D_FF, D_MODEL), jnp.float32) * (D_FF ** -0.5) * DEEPNORM_BETA,
        'ln2_w': 1.0 + 0.02 * nrm(ks[14], (DEPTH, D_MODEL), jnp.float32),
        'ln2_b': 0.02 * nrm(ks[15], (DEPTH, D_MODEL), jnp.float32),
    }


def reference(x, c, w_ada, b_ada, w_in, ret_norm_w, gla_gate_w, gla_gate_b, gla_norm_w,
              w_out, ln1_w, ln1_b, w_ff1, w_ff2, ln2_w, ln2_b):
    for l in range(DEPTH):
        mod = jax.nn.silu(c) @ w_ada[l] + b_ada[l]
        shift1, scale1, gate1, shift2, scale2, gate2 = jnp.split(mod, 6, axis=-1)
        u = _layer_norm(x) * (1.0 + scale1[:, None, :]) + shift1[:, None, :]
        m = _token_mixer(u, w_in[l], ret_norm_w[l], gla_gate_w[l], gla_gate_b[l],
                         gla_norm_w[l], w_out[l])
        x = _layer_norm(DEEPNORM_ALPHA * x + gate1[:, None, :] * m, ln1_w[l], ln1_b[l])
        u2 = _layer_norm(x) * (1.0 + scale2[:, None, :]) + shift2[:, None, :]
        f = jnp.square(jax.nn.relu(u2 @ w_ff1[l])) @ w_ff2[l]
        x = _layer_norm(DEEPNORM_ALPHA * x + gate2[:, None, :] * f, ln2_w[l], ln2_b[l])
    return x
```

```cpp
#include <hip/hip_runtime.h>
#include <cstdint>
#include <cstdio>

namespace {
constexpr int BATCH = 2, SEQ = 8192, D = 1024, M = BATCH * SEQ, NP = 3600, FF = 4096, CH = 64, NCH = SEQ / CH;
constexpr int OFF_RQ = 0, OFF_RK = 512, OFF_RV = 1024, OFF_RG = 1536, OFF_GQ = 2048, OFF_GK = 2304, OFF_GV = 2560, OFF_GG = 3072, OFF_GLR = 3584;
constexpr float LN_EPS = 1e-5f;
constexpr float ALPHA = 1.189207115002721f;

typedef unsigned short bf16_t;
__device__ __forceinline__ float bf2f(bf16_t v) { return __uint_as_float((unsigned)v << 16); }
__device__ __forceinline__ bf16_t f2bf(float f) { unsigned u = __float_as_uint(f); return (bf16_t)((u + 0x7fffu + ((u >> 16) & 1u)) >> 16); }
__device__ __forceinline__ float wave_sum(float v) {
#pragma unroll
    for (int o = 1; o < 64; o <<= 1) v += __shfl_xor(v, o);
    return v;
}
__device__ __forceinline__ float silu(float v) { return v / (1.f + expf(-v)); }

constexpr size_t MiB = 1u << 20;
constexpr size_t WS_MOD = 0;
constexpr size_t WS_TAB = 1 * MiB;
constexpr size_t WS_XN = 5 * MiB;
constexpr size_t WS_MIX = 37 * MiB;
constexpr size_t WS_PROJ = 69 * MiB;
constexpr size_t WS_H = 37 * MiB;
constexpr size_t WS_GST = 192 * MiB;
constexpr size_t WS_BC = 224 * MiB;
constexpr size_t WS_X1 = 192 * MiB;

__global__ void k_mod(const float* __restrict__ c, const float* __restrict__ w_ada, const float* __restrict__ b_ada, float* __restrict__ mod) {
    __shared__ float s[2][1024];
    for (int i = threadIdx.x; i < 2048; i += 256) s[i >> 10][i & 1023] = silu(c[i]);
    __syncthreads();
    const int j = blockIdx.x * 256 + threadIdx.x;
    float a0 = 0.f, a1 = 0.f;
    for (int k = 0; k < 1024; ++k) { const float w = w_ada[(size_t)k * 6144 + j]; a0 += s[0][k] * w; a1 += s[1][k] * w; }
    mod[j] = a0 + b_ada[j]; mod[6144 + j] = a1 + b_ada[j];
}

__global__ void k_tab(float2* __restrict__ tab) {
    const int idx = blockIdx.x * 256 + threadIdx.x; const int pos = idx >> 6, i = idx & 63;
    const float lin = (float)i / 63.0f;
    const float p = (float)pow(10000.0, (double)lin);
    const float inv = 1.0f / p;
    const float ang = (float)pos * inv;
    tab[idx] = make_float2((float)cos((double)ang), (float)sin((double)ang));
}

__global__ void k_lnmod(const float* __restrict__ x, const float* __restrict__ mod, int off_shift, int off_scale, bf16_t* __restrict__ out) {
    const int row = blockIdx.x * 4 + (threadIdx.x >> 6), lane = threadIdx.x & 63, b = row / SEQ;
    const float4* xr = (const float4*)(x + (size_t)row * D) + lane;
    float4 v[4]; float s = 0.f;
#pragma unroll
    for (int j = 0; j < 4; ++j) { v[j] = xr[64 * j]; s += (v[j].x + v[j].y) + (v[j].z + v[j].w); }
    const float mean = wave_sum(s) * (1.f / D); float s2 = 0.f;
#pragma unroll
    for (int j = 0; j < 4; ++j) { v[j].x -= mean; v[j].y -= mean; v[j].z -= mean; v[j].w -= mean; s2 += (v[j].x * v[j].x + v[j].y * v[j].y) + (v[j].z * v[j].z + v[j].w * v[j].w); }
    const float rstd = 1.f / sqrtf(wave_sum(s2) * (1.f / D) + LN_EPS);
    const float* sh = mod + b * 6144 + off_shift; const float* sc = mod + b * 6144 + off_scale;
#pragma unroll
    for (int j = 0; j < 4; ++j) { const int col = j * 256 + lane * 4; const float4 a = *(const float4*)(sc + col), c4 = *(const float4*)(sh + col);
        ushort4 o; o.x = f2bf(v[j].x * rstd * (1.f + a.x) + c4.x); o.y = f2bf(v[j].y * rstd * (1.f + a.y) + c4.y); o.z = f2bf(v[j].z * rstd * (1.f + a.z) + c4.z); o.w = f2bf(v[j].w * rstd * (1.f + a.w) + c4.w);
        *(ushort4*)(out + (size_t)row * D + col) = o; }
}

template <int EPI>
__global__ void __launch_bounds__(256) k_gemm(const bf16_t* __restrict__ A, int lda, const float* __restrict__ Bm, int ldb, void* __restrict__ C, int ldc, int N, int K) {
    __shared__ float As[16][68], Bs[16][68];
    const int tid = threadIdx.x, tx = tid & 15, ty = tid >> 4;
    const int row0 = blockIdx.y * 64, col0 = blockIdx.x * 64;
    float acc[4][4];
#pragma unroll
    for (int i = 0; i < 4; ++i)
#pragma unroll
        for (int j = 0; j < 4; ++j) acc[i][j] = 0.f;
    const int ar = tid >> 2, ak = (tid & 3) * 4;
    const int bk = tid >> 4, bn = (tid & 15) * 4;
    for (int k0 = 0; k0 < K; k0 += 16) {
        const ushort4 a = *(const ushort4*)(A + (size_t)(row0 + ar) * lda + k0 + ak);
        float4 bv = make_float4(0.f, 0.f, 0.f, 0.f);
        if (col0 + bn < N) bv = *(const float4*)(Bm + (size_t)(k0 + bk) * ldb + col0 + bn);
        __syncthreads();
        As[ak + 0][ar] = bf2f(a.x); As[ak + 1][ar] = bf2f(a.y); As[ak + 2][ar] = bf2f(a.z); As[ak + 3][ar] = bf2f(a.w);
        *(float4*)&Bs[bk][bn] = bv;
        __syncthreads();
#pragma unroll
        for (int k = 0; k < 16; ++k) {
            const float4 av = *(const float4*)&As[k][ty * 4]; const float4 b4 = *(const float4*)&Bs[k][tx * 4];
            const float aa[4] = {av.x, av.y, av.z, av.w}, bb[4] = {b4.x, b4.y, b4.z, b4.w};
#pragma unroll
            for (int i = 0; i < 4; ++i)
#pragma unroll
                for (int j = 0; j < 4; ++j) acc[i][j] += aa[i] * bb[j];
        }
    }
    const int c = col0 + tx * 4;
    if (c < N) {
#pragma unroll
        for (int i = 0; i < 4; ++i) { const size_t r = (size_t)(row0 + ty * 4 + i);
            if (EPI == 1) { *(float4*)((float*)C + r * ldc + c) = make_float4(acc[i][0], acc[i][1], acc[i][2], acc[i][3]); }
            else { float v[4];
#pragma unroll
                for (int j = 0; j < 4; ++j) { float t = acc[i][j]; if (EPI == 2) { t = t > 0.f ? t : 0.f; t = t * t; } v[j] = t; }
                ushort4 o; o.x = f2bf(v[0]); o.y = f2bf(v[1]); o.z = f2bf(v[2]); o.w = f2bf(v[3]);
                *(ushort4*)((bf16_t*)C + r * ldc + c) = o; } }
    }
}

__global__ void k_gate(const bf16_t* __restrict__ proj, const float* __restrict__ gw, const float* __restrict__ gb, float* __restrict__ bcum) {
    __shared__ float g[64][16];
    const int chunk = blockIdx.x, ch = threadIdx.x;
    for (int i = threadIdx.x; i < 1024; i += 256) { const int t = i >> 4, r = i & 15; g[t][r] = bf2f(proj[(size_t)(chunk * 64 + t) * NP + OFF_GLR + r]); }
    float w[16];
#pragma unroll
    for (int r = 0; r < 16; ++r) w[r] = gw[r * 256 + ch];
    const float bias = gb[ch];
    __syncthreads();
    float cum = 0.f;
    for (int t = 0; t < 64; ++t) {
        float z = bias;
#pragma unroll
        for (int r = 0; r < 16; ++r) z += g[t][r] * w[r];
        const float ls = fminf(z, 0.f) - log1pf(expf(-fabsf(z)));
        cum += ls * (1.0f / 16.0f);
        bcum[(size_t)(chunk * 64 + t) * 256 + ch] = cum;
    }
}

__global__ void __launch_bounds__(256) k_retU(const bf16_t* __restrict__ proj, const float2* __restrict__ tab, float* __restrict__ U) {
    extern __shared__ float sm[];
    float (*ks)[128] = (float (*)[128])sm; float (*vs)[128] = (float (*)[128])(sm + 64 * 128);
    const int unit = blockIdx.x, h = unit & 3, cn = unit >> 2, n = cn & 127; const size_t row0 = (size_t)cn * 64;
    const float lg = logf(1.0f - exp2f(-5.0f - (float)h));
    for (int i = threadIdx.x; i < 64 * 64; i += 256) { const int s = i >> 6, j = i & 63;
        const bf16_t* kp = proj + (row0 + s) * NP + OFF_RK + h * 128; const float k1 = bf2f(kp[j]), k2 = bf2f(kp[j + 64]);
        const float2 cs = tab[(n * 64 + s) * 64 + j]; const float dec = expf(lg * (63.0f - (float)s));
        ks[s][j] = (k1 * cs.x - k2 * cs.y) * dec; ks[s][j + 64] = (k2 * cs.x + k1 * cs.y) * dec; }
    for (int i = threadIdx.x; i < 64 * 128; i += 256) { const int s = i >> 7, e = i & 127; vs[s][e] = bf2f(proj[(row0 + s) * NP + OFF_RV + h * 128 + e]); }
    __syncthreads();
    const int d = threadIdx.x >> 1, e0 = (threadIdx.x & 1) * 64;
    float acc[64];
#pragma unroll
    for (int j = 0; j < 64; ++j) acc[j] = 0.f;
    for (int s = 0; s < 64; ++s) { const float kd = ks[s][d];
#pragma unroll
        for (int j = 0; j < 64; ++j) acc[j] += kd * vs[s][e0 + j]; }
    float* up = U + (size_t)unit * 16384 + d * 128 + e0;
#pragma unroll
    for (int j = 0; j < 64; ++j) up[j] = acc[j];
}
__global__ void k_scan_ret(float* __restrict__ U) {
    const int idx = blockIdx.x * 256 + threadIdx.x; const int bh = idx >> 14, de = idx & 16383, b = bh >> 2, h = bh & 3;
    const float lg = logf(1.0f - exp2f(-5.0f - (float)h)); const float cd = expf(lg * 64.0f);
    float r = 0.f;
    for (int n = 0; n < NCH; ++n) { float* p = U + (size_t)(((b * NCH + n) * 4) + h) * 16384 + de; const float t = *p; *p = r; r = cd * r + t; }
}
__global__ void __launch_bounds__(256) k_retO(const bf16_t* __restrict__ proj, const float2* __restrict__ tab, const float* __restrict__ R, const float* __restrict__ nw, bf16_t* __restrict__ mixed) {
    extern __shared__ float sm[];
    float (*qs)[128] = (float (*)[128])sm; float (*ks)[128] = (float (*)[128])(sm + 8192); float (*vs)[128] = (float (*)[128])(sm + 16384); float (*sc)[64] = (float (*)[64])(sm + 24576);
    const int unit = blockIdx.x, h = unit & 3, cn = unit >> 2, n = cn & 127; const size_t row0 = (size_t)cn * 64;
    const float lg = logf(1.0f - exp2f(-5.0f - (float)h));
    for (int i = threadIdx.x; i < 64 * 64; i += 256) { const int s = i >> 6, j = i & 63; const float2 cs = tab[(n * 64 + s) * 64 + j];
        const bf16_t* qp = proj + (row0 + s) * NP + OFF_RQ + h * 128; const float q1 = bf2f(qp[j]), q2 = bf2f(qp[j + 64]);
        const bf16_t* kp = proj + (row0 + s) * NP + OFF_RK + h * 128; const float k1 = bf2f(kp[j]), k2 = bf2f(kp[j + 64]);
        const float qsc = 0.08838834764831845f;
        qs[s][j] = (q1 * cs.x - q2 * cs.y) * qsc; qs[s][j + 64] = (q2 * cs.x + q1 * cs.y) * qsc;
        ks[s][j] = (k1 * cs.x - k2 * cs.y); ks[s][j + 64] = (k2 * cs.x + k1 * cs.y); }
    for (int i = threadIdx.x; i < 64 * 128; i += 256) { const int s = i >> 7, e = i & 127; vs[s][e] = bf2f(proj[(row0 + s) * NP + OFF_RV + h * 128 + e]); }
    __syncthreads();
    const int c = threadIdx.x >> 2, q4 = threadIdx.x & 3;
    { float a[16];
#pragma unroll
        for (int j = 0; j < 16; ++j) a[j] = 0.f;
        for (int d = 0; d < 128; ++d) { const float qv = qs[c][d];
#pragma unroll
            for (int j = 0; j < 16; ++j) a[j] += qv * ks[q4 * 16 + j][d]; }
#pragma unroll
        for (int j = 0; j < 16; ++j) { const int s = q4 * 16 + j; sc[c][s] = a[j] * expf(lg * fabsf((float)(c - s))); } }
    __syncthreads();
    const int e0 = q4 * 32;
    float o[32];
#pragma unroll
    for (int j = 0; j < 32; ++j) o[j] = 0.f;
    for (int s = 0; s < 64; ++s) { const float p = sc[c][s];
#pragma unroll
        for (int j = 0; j < 32; ++j) o[j] += p * vs[s][e0 + j]; }
    const float qd = expf(lg * (float)(c + 1));
    const float* Rp = R + (size_t)unit * 16384 + e0;
    for (int d = 0; d < 128; ++d) { const float qv = qs[c][d] * qd;
#pragma unroll
        for (int j = 0; j < 32; j += 4) { const float4 r4 = *(const float4*)(Rp + d * 128 + j); o[j] += qv * r4.x; o[j + 1] += qv * r4.y; o[j + 2] += qv * r4.z; o[j + 3] += qv * r4.w; } }
    float s1 = 0.f;
#pragma unroll
    for (int j = 0; j < 32; ++j) s1 += o[j];
    s1 += __shfl_xor(s1, 1); s1 += __shfl_xor(s1, 2);
    const float mean = s1 * (1.f / 128.f); float s2 = 0.f;
#pragma unroll
    for (int j = 0; j < 32; ++j) { o[j] -= mean; s2 += o[j] * o[j]; }
    s2 += __shfl_xor(s2, 1); s2 += __shfl_xor(s2, 2);
    const float rstd = 1.f / sqrtf(s2 * (1.f / 128.f) + LN_EPS);
#pragma unroll
    for (int j = 0; j < 32; ++j) { const int e = e0 + j; const float g = bf2f(proj[(row0 + c) * NP + OFF_RG + h * 128 + e]);
        mixed[(row0 + c) * D + h * 128 + e] = f2bf(o[j] * rstd * nw[h * 128 + e] * silu(g)); }
}

__global__ void __launch_bounds__(256) k_glaU(const bf16_t* __restrict__ proj, const float* __restrict__ bcum, float* __restrict__ U) {
    extern __shared__ float sm[];
    float (*ks)[64] = (float (*)[64])sm; float (*vs)[128] = (float (*)[128])(sm + 4096);
    const int unit = blockIdx.x, h = unit & 3, cn = unit >> 2; const size_t row0 = (size_t)cn * 64;
    for (int i = threadIdx.x; i < 64 * 64; i += 256) { const int s = i >> 6, d = i & 63;
        const float bl = bcum[(row0 + 63) * 256 + h * 64 + d], bb = bcum[(row0 + s) * 256 + h * 64 + d];
        ks[s][d] = bf2f(proj[(row0 + s) * NP + OFF_GK + h * 64 + d]) * expf(bl - bb); }
    for (int i = threadIdx.x; i < 64 * 128; i += 256) { const int s = i >> 7, e = i & 127; vs[s][e] = bf2f(proj[(row0 + s) * NP + OFF_GV + h * 128 + e]); }
    __syncthreads();
    const int d = threadIdx.x >> 2, e0 = (threadIdx.x & 3) * 32;
    float acc[32];
#pragma unroll
    for (int j = 0; j < 32; ++j) acc[j] = 0.f;
    for (int s = 0; s < 64; ++s) { const float kd = ks[s][d];
#pragma unroll
        for (int j = 0; j < 32; ++j) acc[j] += kd * vs[s][e0 + j]; }
    float* up = U + (size_t)unit * 8192 + d * 128 + e0;
#pragma unroll
    for (int j = 0; j < 32; ++j) up[j] = acc[j];
}
__global__ void k_scan_gla(float* __restrict__ U, const float* __restrict__ bcum) {
    const int idx = blockIdx.x * 256 + threadIdx.x; const int bh = idx >> 13, de = idx & 8191, b = bh >> 2, h = bh & 3, d = de >> 7;
    float r = 0.f;
    for (int n = 0; n < NCH; ++n) { float* p = U + (size_t)(((b * NCH + n) * 4) + h) * 8192 + de;
        const float dec = expf(bcum[((size_t)(b * NCH + n) * 64 + 63) * 256 + h * 64 + d]);
        const float t = *p; *p = r; r = dec * r + t; }
}
__global__ void __launch_bounds__(256) k_glaO(const bf16_t* __restrict__ proj, const float* __restrict__ bcum, const float* __restrict__ St, const float* __restrict__ nw, bf16_t* __restrict__ mixed) {
    extern __shared__ float sm[];
    float (*qs)[64] = (float (*)[64])sm; float (*ks)[64] = (float (*)[64])(sm + 4096); float (*bs)[64] = (float (*)[64])(sm + 8192); float (*vs)[128] = (float (*)[128])(sm + 12288); float (*sc)[64] = (float (*)[64])(sm + 20480);
    const int unit = blockIdx.x, h = unit & 3, cn = unit >> 2; const size_t row0 = (size_t)cn * 64;
    for (int i = threadIdx.x; i < 64 * 64; i += 256) { const int s = i >> 6, d = i & 63;
        qs[s][d] = bf2f(proj[(row0 + s) * NP + OFF_GQ + h * 64 + d]) * 0.125f; ks[s][d] = bf2f(proj[(row0 + s) * NP + OFF_GK + h * 64 + d]);
        bs[s][d] = bcum[(row0 + s) * 256 + h * 64 + d]; }
    for (int i = threadIdx.x; i < 64 * 128; i += 256) { const int s = i >> 7, e = i & 127; vs[s][e] = bf2f(proj[(row0 + s) * NP + OFF_GV + h * 128 + e]); }
    __syncthreads();
    const int t = threadIdx.x >> 2, q4 = threadIdx.x & 3;
    { float a[16];
#pragma unroll
        for (int j = 0; j < 16; ++j) a[j] = 0.f;
        for (int d = 0; d < 64; ++d) { const float qv = qs[t][d], bt = bs[t][d];
#pragma unroll
            for (int j = 0; j < 16; ++j) { const int s = q4 * 16 + j; a[j] += qv * ks[s][d] * expf(-fabsf(bt - bs[s][d])); } }
#pragma unroll
        for (int j = 0; j < 16; ++j) sc[t][q4 * 16 + j] = a[j]; }
    __syncthreads();
    const int e0 = q4 * 32;
    float o[32];
#pragma unroll
    for (int j = 0; j < 32; ++j) o[j] = 0.f;
    for (int s = 0; s < 64; ++s) { const float p = sc[t][s];
#pragma unroll
        for (int j = 0; j < 32; ++j) o[j] += p * vs[s][e0 + j]; }
    const float* Sp = St + (size_t)unit * 8192 + e0;
    for (int d = 0; d < 64; ++d) { const float qv = qs[t][d] * expf(bs[t][d]);
#pragma unroll
        for (int j = 0; j < 32; j += 4) { const float4 r4 = *(const float4*)(Sp + d * 128 + j); o[j] += qv * r4.x; o[j + 1] += qv * r4.y; o[j + 2] += qv * r4.z; o[j + 3] += qv * r4.w; } }
    float s2 = 0.f;
#pragma unroll
    for (int j = 0; j < 32; ++j) s2 += o[j] * o[j];
    s2 += __shfl_xor(s2, 1); s2 += __shfl_xor(s2, 2);
    const float rstd = 1.f / sqrtf(s2 * (1.f / 128.f) + LN_EPS);
#pragma unroll
    for (int j = 0; j < 32; ++j) { const int e = e0 + j; const float g = bf2f(proj[(row0 + t) * NP + OFF_GG + h * 128 + e]);
        mixed[(row0 + t) * D + 512 + h * 128 + e] = f2bf(o[j] * rstd * nw[h * 128 + e] * silu(g)); }
}

template <bool XN>
__global__ void k_lnres(const float* __restrict__ base, const float* br, const float* __restrict__ mod, int off_gate, const float* __restrict__ w, const float* __restrict__ bias,
                        float* yout, int off_shift, int off_scale, bf16_t* __restrict__ xn) {
    const int row = blockIdx.x * 4 + (threadIdx.x >> 6), lane = threadIdx.x & 63, b = row / SEQ;
    const float* gt = mod + b * 6144 + off_gate;
    float4 v[4]; float s = 0.f;
#pragma unroll
    for (int j = 0; j < 4; ++j) { const int col = j * 256 + lane * 4; const float4 xb = *(const float4*)(base + (size_t)row * D + col), m4 = *(const float4*)(br + (size_t)row * D + col), g4 = *(const float4*)(gt + col);
        v[j].x = ALPHA * xb.x + g4.x * m4.x; v[j].y = ALPHA * xb.y + g4.y * m4.y; v[j].z = ALPHA * xb.z + g4.z * m4.z; v[j].w = ALPHA * xb.w + g4.w * m4.w;
        s += (v[j].x + v[j].y) + (v[j].z + v[j].w); }
    float mean = wave_sum(s) * (1.f / D); float s2 = 0.f;
#pragma unroll
    for (int j = 0; j < 4; ++j) { v[j].x -= mean; v[j].y -= mean; v[j].z -= mean; v[j].w -= mean; s2 += (v[j].x * v[j].x + v[j].y * v[j].y) + (v[j].z * v[j].z + v[j].w * v[j].w); }
    float rstd = 1.f / sqrtf(wave_sum(s2) * (1.f / D) + LN_EPS);
    s = 0.f;
#pragma unroll
    for (int j = 0; j < 4; ++j) { const int col = j * 256 + lane * 4; const float4 w4 = *(const float4*)(w + col), b4 = *(const float4*)(bias + col);
        v[j].x = v[j].x * rstd * w4.x + b4.x; v[j].y = v[j].y * rstd * w4.y + b4.y; v[j].z = v[j].z * rstd * w4.z + b4.z; v[j].w = v[j].w * rstd * w4.w + b4.w;
        *(float4*)(yout + (size_t)row * D + col) = v[j]; s += (v[j].x + v[j].y) + (v[j].z + v[j].w); }
    if (XN) {
        mean = wave_sum(s) * (1.f / D); s2 = 0.f;
#pragma unroll
        for (int j = 0; j < 4; ++j) { v[j].x -= mean; v[j].y -= mean; v[j].z -= mean; v[j].w -= mean; s2 += (v[j].x * v[j].x + v[j].y * v[j].y) + (v[j].z * v[j].z + v[j].w * v[j].w); }
        rstd = 1.f / sqrtf(wave_sum(s2) * (1.f / D) + LN_EPS);
        const float* sh = mod + b * 6144 + off_shift; const float* sc = mod + b * 6144 + off_scale;
#pragma unroll
        for (int j = 0; j < 4; ++j) { const int col = j * 256 + lane * 4; const float4 a = *(const float4*)(sc + col), c4 = *(const float4*)(sh + col);
            ushort4 o; o.x = f2bf(v[j].x * rstd * (1.f + a.x) + c4.x); o.y = f2bf(v[j].y * rstd * (1.f + a.y) + c4.y); o.z = f2bf(v[j].z * rstd * (1.f + a.z) + c4.z); o.w = f2bf(v[j].w * rstd * (1.f + a.w) + c4.w);
            *(ushort4*)(xn + (size_t)row * D + col) = o; }
    }
}
}

extern "C" void kernel_launch(void* const* d_in, const int* in_sizes, int n_in, void* d_out, int out_size, void* d_ws, size_t ws_size, hipStream_t stream) {
    const float* x = (const float*)d_in[0]; const float* c = (const float*)d_in[1]; const float* w_ada = (const float*)d_in[2]; const float* b_ada = (const float*)d_in[3];
    const float* w_in = (const float*)d_in[4]; const float* ret_nw = (const float*)d_in[5]; const float* gate_w = (const float*)d_in[6]; const float* gate_b = (const float*)d_in[7];
    const float* gla_nw = (const float*)d_in[8]; const float* w_out = (const float*)d_in[9]; const float* ln1_w = (const float*)d_in[10]; const float* ln1_b = (const float*)d_in[11];
    const float* w_ff1 = (const float*)d_in[12]; const float* w_ff2 = (const float*)d_in[13]; const float* ln2_w = (const float*)d_in[14]; const float* ln2_b = (const float*)d_in[15];
    unsigned char* ws = (unsigned char*)d_ws; float* out = (float*)d_out;
    float* mod = (float*)(ws + WS_MOD); float2* tab = (float2*)(ws + WS_TAB); bf16_t* XN = (bf16_t*)(ws + WS_XN); bf16_t* MIX = (bf16_t*)(ws + WS_MIX);
    bf16_t* PROJ = (bf16_t*)(ws + WS_PROJ); bf16_t* H = (bf16_t*)(ws + WS_H); float* GST = (float*)(ws + WS_GST); float* BC = (float*)(ws + WS_BC); float* X1 = (float*)(ws + WS_X1);
    float* RST = out;
    static bool attr = false;
    if (!attr) { attr = true;
        hipFuncSetAttribute((const void*)k_retU, hipFuncAttributeMaxDynamicSharedMemorySize, 65536);
        hipFuncSetAttribute((const void*)k_retO, hipFuncAttributeMaxDynamicSharedMemorySize, 114688);
        hipFuncSetAttribute((const void*)k_glaU, hipFuncAttributeMaxDynamicSharedMemorySize, 49152);
        hipFuncSetAttribute((const void*)k_glaO, hipFuncAttributeMaxDynamicSharedMemorySize, 98304); }
    k_mod<<<24, 256, 0, stream>>>(c, w_ada, b_ada, mod);
    k_tab<<<SEQ * 64 / 256, 256, 0, stream>>>(tab);
    k_lnmod<<<M / 4, 256, 0, stream>>>(x, mod, 0, 1024, XN);
    k_gemm<0><<<dim3((NP + 63) / 64, M / 64), 256, 0, stream>>>(XN, D, w_in, NP, PROJ, NP, NP, D);
    k_gate<<<BATCH * NCH, 256, 0, stream>>>(PROJ, gate_w, gate_b, BC);
    k_retU<<<BATCH * NCH * 4, 256, 65536, stream>>>(PROJ, tab, RST);
    k_glaU<<<BATCH * NCH * 4, 256, 49152, stream>>>(PROJ, BC, GST);
    k_scan_ret<<<BATCH * 4 * 16384 / 256, 256, 0, stream>>>(RST);
    k_scan_gla<<<BATCH * 4 * 8192 / 256, 256, 0, stream>>>(GST, BC);
    k_retO<<<BATCH * NCH * 4, 256, 114688, stream>>>(PROJ, tab, RST, ret_nw, MIX);
    k_glaO<<<BATCH * NCH * 4, 256, 98304, stream>>>(PROJ, BC, GST, gla_nw, MIX);
    k_gemm<1><<<dim3(D / 64, M / 64), 256, 0, stream>>>(MIX, D, w_out, D, out, D, D, D);
    k_lnres<true><<<M / 4, 256, 0, stream>>>(x, out, mod, 2048, ln1_w, ln1_b, X1, 3072, 4096, XN);
    k_gemm<2><<<dim3(FF / 64, M / 64), 256, 0, stream>>>(XN, D, w_ff1, FF, H, FF, FF, D);
    k_gemm<1><<<dim3(D / 64, M / 64), 256, 0, stream>>>(H, FF, w_ff2, D, out, D, D, FF);
    k_lnres<false><<<M / 4, 256, 0, stream>>>(X1, out, mod, 5120, ln2_w, ln2_b, out, 0, 0, nullptr);
}
```
